# Optimizing an MI355X kernel written in HIP

```python
import jax
import jax.numpy as jnp
from jax import lax
import numpy as np

D_MODEL = 1024
BATCH = 2
SEQ = 16384
DEPTH = 4

GRID_W = 64
CTX_LEN = 256

N_MIXERS = 3
N_ATTN_LAYERS = len(range(0, DEPTH, N_MIXERS))
N_LRU_LAYERS = len(range(1, DEPTH, N_MIXERS))
N_CONV_LAYERS = len(range(2, DEPTH, N_MIXERS))

HEAD_DIM = 64
N_HEADS = D_MODEL // HEAD_DIM
N_KV_HEADS = 4
GROUP = N_HEADS // N_KV_HEADS
WINDOW = 128
BLOCK = 128
ROPE_BASE = 10000.0

D_RNN = D_MODEL
LRU_BLOCK_W = 256
N_LRU_BLOCKS = D_RNN // LRU_BLOCK_W
LRU_CONV_W = 4
LRU_CONV_PAD = (LRU_CONV_W // 2, LRU_CONV_W - 1 - LRU_CONV_W // 2)
LRU_C = 8.0

CONV_K = 31
CONV_PAD = (CONV_K // 2, CONV_K // 2)

N_EXPERTS = 16
D_FF_EXPERT = 2 * D_MODEL
EC_CAPACITY_FACTOR = 2

DEEPNORM_ALPHA = (2 * DEPTH) ** 0.25
DEEPNORM_BETA = (8 * DEPTH) ** -0.25
LN_EPS = 1e-5
NEG_INF = -1e30

kernel_name = "hybrid_interleaved_diffusion_trunk"


def layer_norm(x, g, b):
    xf = x.astype(jnp.float32)
    mu = jnp.mean(xf, axis=-1, keepdims=True)
    var = jnp.mean(jnp.square(xf - mu), axis=-1, keepdims=True)
    y = (xf - mu) * lax.rsqrt(var + LN_EPS) * g.astype(jnp.float32) + b.astype(jnp.float32)
    return y.astype(x.dtype)


def depthwise_conv(x, w, b, pad):
    y = lax.conv_general_dilated(
        x, w[:, None, :], window_strides=(1,), padding=[pad],
        dimension_numbers=("NWC", "WIO", "NWC"), feature_group_count=x.shape[-1])
    return y + b


def axial_rope_tables(n):
    rows = n // GRID_W
    row = jnp.broadcast_to(jnp.arange(rows, dtype=jnp.float32)[:, None], (rows, GRID_W)).reshape(-1)
    col = jnp.broadcast_to(jnp.arange(GRID_W, dtype=jnp.float32)[None, :], (rows, GRID_W)).reshape(-1)
    n_freq = HEAD_DIM // 4
    inv = ROPE_BASE ** (-jnp.arange(n_freq, dtype=jnp.float32) / n_freq)
    ang = jnp.concatenate([row[:, None] * inv, col[:, None] * inv], axis=-1)
    return jnp.cos(ang), jnp.sin(ang)


def apply_rope(t, cos, sin):
    tf = t.astype(jnp.float32)
    t1, t2 = tf[..., :HEAD_DIM // 2], tf[..., HEAD_DIM // 2:]
    cs, sn = cos[None, :, None, :], sin[None, :, None, :]
    return jnp.concatenate([t1 * cs - t2 * sn, t2 * cs + t1 * sn], axis=-1).astype(t.dtype)


def split_qkv(t, w_qkv):
    bsz, n, _ = t.shape
    q_w, kv_w = N_HEADS * HEAD_DIM, N_KV_HEADS * HEAD_DIM
    z = t @ w_qkv
    q = z[..., :q_w].reshape(bsz, n, N_HEADS, HEAD_DIM)
    k = z[..., q_w:q_w + kv_w].reshape(bsz, n, N_KV_HEADS, HEAD_DIM)
    v = z[..., q_w + kv_w:].reshape(bsz, n, N_KV_HEADS, HEAD_DIM)
    return q, k, v


def windowed_sink_gqa(u, uc, w_qkv, sink, w_o, cos, sin, need_ctx):
    bsz, n, _ = u.shape
    scale = HEAD_DIM ** -0.5
    q, k, v = split_qkv(u, w_qkv)
    q = (apply_rope(q, cos, sin) * scale).reshape(bsz, n, N_KV_HEADS, GROUP, HEAD_DIM)
    k = apply_rope(k, cos, sin)
    qc, kc, vc = split_qkv(uc, w_qkv)
    n_ctx = kc.shape[1]
    span = BLOCK + 2 * WINDOW
    kp = jnp.pad(k, ((0, 0), (WINDOW, WINDOW), (0, 0), (0, 0)))
    vp = jnp.pad(v, ((0, 0), (WINDOW, WINDOW), (0, 0), (0, 0)))
    sink_logit = sink.astype(jnp.float32).reshape(1, N_KV_HEADS, GROUP, 1, 1)

    def attend_block(start):
        qb = lax.dynamic_slice_in_dim(q, start, BLOCK, axis=1)
        kb = lax.dynamic_slice_in_dim(kp, start, span, axis=1)
        vb = lax.dynamic_slice_in_dim(vp, start, span, axis=1)
        qpos = start + jnp.arange(BLOCK)
        kpos = start - WINDOW + jnp.arange(span)
        valid = (jnp.abs(qpos[:, None] - kpos[None, :]) <= WINDOW) & (kpos >= 0) & (kpos < n)
        s_loc = jnp.einsum("bqhgd,bkhd->bhgqk", qb, kb).astype(jnp.float32)
        s_loc = jnp.where(valid, s_loc, NEG_INF)
        s_ctx = jnp.einsum("bqhgd,bchd->bhgqc", qb, kc).astype(jnp.float32)
        sinks = jnp.broadcast_to(sink_logit, s_ctx.shape[:-1] + (1,))
        p = jax.nn.softmax(jnp.concatenate([s_ctx, s_loc, sinks], axis=-1), axis=-1).astype(v.dtype)
        return (jnp.einsum("bhgqc,bchd->bqhgd", p[..., :n_ctx], vc)
                + jnp.einsum("bhgqk,bkhd->bqhgd", p[..., n_ctx:n_ctx + span], vb))

    o = lax.map(attend_block, jnp.arange(n // BLOCK) * BLOCK)
    y = jnp.moveaxis(o, 0, 1).reshape(bsz, n, N_HEADS * HEAD_DIM) @ w_o
    yc = None
    if need_ctx:
        qcg = (qc * scale).reshape(bsz, n_ctx, N_KV_HEADS, GROUP, HEAD_DIM)
        s = jnp.einsum("bqhgd,bchd->bhgqc", qcg, kc).astype(jnp.float32)
        sinks = jnp.broadcast_to(sink_logit, s.shape[:-1] + (1,))
        p = jax.nn.softmax(jnp.concatenate([s, sinks], axis=-1), axis=-1)[..., :n_ctx].astype(vc.dtype)
        yc = jnp.einsum("bhgqc,bchd->bqhgd", p, vc).reshape(bsz, n_ctx, N_HEADS * HEAD_DIM) @ w_o
    return y, yc


def rglru_coeffs(xr, gate_a_w, gate_a_b, gate_x_w, gate_x_b, lam, reset_pos):
    bsz, n, _ = xr.shape
    xb = xr.reshape(bsz, n, N_LRU_BLOCKS, LRU_BLOCK_W)
    r = jax.nn.sigmoid((jnp.einsum("bsnc,ncd->bsnd", xb, gate_a_w).reshape(bsz, n, D_RNN)
                        + gate_a_b).astype(jnp.float32))
    i = jax.nn.sigmoid((jnp.einsum("bsnc,ncd->bsnd", xb, gate_x_w).reshape(bsz, n, D_RNN)
                        + gate_x_b).astype(jnp.float32))
    log_a = -LRU_C * r * jax.nn.softplus(-lam.astype(jnp.float32))
    a = jnp.exp(log_a)
    mult = jnp.sqrt(-jnp.expm1(2.0 * log_a))
    if reset_pos is not None:
        mult = jnp.where(jnp.arange(n)[None, :, None] == reset_pos, 1.0, mult)
    return a, mult * i * xr.astype(jnp.float32)


def linear_scan(a, b, h0, reverse):
    if h0 is not None:
        edge = -1 if reverse else 0
        b = b.at[:, edge].add(a[:, edge] * h0)

    def combine(first, second):
        return first[0] * second[0], second[0] * first[1] + second[1]

    _, h = lax.associative_scan(combine, (a, b), reverse=reverse, axis=1)
    return h


def rglru_mixer(u, uc, w_in, conv_w, conv_b, gate_a_w, gate_a_b, gate_x_w, gate_x_b, lam, w_out,
                need_ctx):
    n_ctx = uc.shape[1]

    def branches(t):
        gate, rec = jnp.split(t @ w_in, 2, axis=-1)
        return jax.nn.gelu(gate), depthwise_conv(rec, conv_w, conv_b, LRU_CONV_PAD)

    g, xr = branches(u)
    gc, xrc = branches(uc)
    a_cf, b_cf = rglru_coeffs(xrc, gate_a_w[0], gate_a_b[0], gate_x_w[0], gate_x_b[0], lam[0], 0)
    a_cb, b_cb = rglru_coeffs(xrc, gate_a_w[1], gate_a_b[1], gate_x_w[1], gate_x_b[1], lam[1], n_ctx - 1)
    hc_f = linear_scan(a_cf, b_cf, None, False)
    hc_b = linear_scan(a_cb, b_cb, None, True)
    a_f, b_f = rglru_coeffs(xr, gate_a_w[0], gate_a_b[0], gate_x_w[0], gate_x_b[0], lam[0], None)
    a_b, b_b = rglru_coeffs(xr, gate_a_w[1], gate_a_b[1], gate_x_w[1], gate_x_b[1], lam[1], None)
    h_f = linear_scan(a_f, b_f, hc_f[:, -1], False)
    h_b = linear_scan(a_b, b_b, hc_b[:, 0], True)
    y = ((h_f + h_b).astype(u.dtype) * g) @ w_out
    yc = (((hc_f + hc_b).astype(uc.dtype) * gc) @ w_out) if need_ctx else None
    return y, yc


def conformer_conv(u, uc, w_in, b_in, dw_w, dw_b, ln_g, ln_b, w_out, b_out, need_ctx):
    def module(t):
        val, gt = jnp.split(t @ w_in + b_in, 2, axis=-1)
        z = val * jax.nn.sigmoid(gt)
        z = depthwise_conv(z, dw_w, dw_b, CONV_PAD)
        z = jax.nn.silu(layer_norm(z, ln_g, ln_b))
        return z @ w_out + b_out

    return module(u), (module(uc) if need_ctx else None)


def expert_choice_ffn(t, router, w1, w3, w2):
    bsz, n, dm = t.shape
    cap = max(1, EC_CAPACITY_FACTOR * n // N_EXPERTS)
    aff = jax.nn.softmax((t @ router).astype(jnp.float32), axis=-1)
    gate, idx = lax.top_k(jnp.swapaxes(aff, 1, 2), cap)
    xg = jax.vmap(lambda tb, ib: tb[ib])(t, idx)
    hid = jax.nn.silu(jnp.einsum("becd,edf->becf", xg, w1)) * jnp.einsum("becd,edf->becf", xg, w3)
    y = jnp.einsum("becf,efd->becd", hid, w2) * gate[..., None].astype(t.dtype)
    return jax.vmap(lambda yb, ib: jnp.zeros((n, dm), yb.dtype).at[ib.reshape(-1)].add(
        yb.reshape(-1, dm)))(y, idx)


def setup_inputs(seed: int = 0) -> dict:
    key = jax.random.key(seed)
    ks = iter(jax.random.split(key, 40))
    f32 = jnp.float32
    D, E, F = D_MODEL, N_EXPERTS, D_FF_EXPERT

    def nrm(shape, scale):
        return jax.random.normal(next(ks), shape, f32) * scale

    def gain(shape):
        return 1.0 + nrm(shape, 0.02)

    qkv_w = (N_HEADS + 2 * N_KV_HEADS) * HEAD_DIM
    a_c = jax.random.uniform(next(ks), (N_LRU_LAYERS, 2, D_RNN), f32, 0.9, 0.999)
    a_base = a_c ** (1.0 / LRU_C)
    lru_lambda = jnp.log(a_base) - jnp.log1p(-a_base)
    return {
        "x": nrm((BATCH, SEQ, D), 1.0),
        "c": nrm((BATCH, D), 1.0),
        "ctx": nrm((BATCH, CTX_LEN, D), 1.0),
        "c_ctx": nrm((D,), 1.0),
        "ada_w": nrm((DEPTH, D, 6 * D), 0.5 * D ** -0.5),
        "ada_b": nrm((DEPTH, 6 * D), 0.02),
        "ln1_g": gain((DEPTH, D)),
        "ln1_b": nrm((DEPTH, D), 0.02),
        "ln2_g": gain((DEPTH, D)),
        "ln2_b": nrm((DEPTH, D), 0.02),
        "attn_w_qkv": nrm((N_ATTN_LAYERS, D, qkv_w), D ** -0.5),
        "attn_sink": nrm((N_ATTN_LAYERS, N_HEADS), 1.0),
        "attn_w_o": nrm((N_ATTN_LAYERS, N_HEADS * HEAD_DIM, D), DEEPNORM_BETA * D ** -0.5),
        "lru_w_in": nrm((N_LRU_LAYERS, D, 2 * D_RNN), D ** -0.5),
        "lru_conv_w": nrm((N_LRU_LAYERS, LRU_CONV_W, D_RNN), LRU_CONV_W ** -0.5),
        "lru_conv_b": nrm((N_LRU_LAYERS, D_RNN), 0.02),
        "lru_gate_a_w": nrm((N_LRU_LAYERS, 2, N_LRU_BLOCKS, LRU_BLOCK_W, LRU_BLOCK_W), LRU_BLOCK_W ** -0.5),
        "lru_gate_a_b": nrm((N_LRU_LAYERS, 2, D_RNN), 0.02),
        "lru_gate_x_w": nrm((N_LRU_LAYERS, 2, N_LRU_BLOCKS, LRU_BLOCK_W, LRU_BLOCK_W), LRU_BLOCK_W ** -0.5),
        "lru_gate_x_b": nrm((N_LRU_LAYERS, 2, D_RNN), 0.02),
        "lru_lambda": lru_lambda,
        "lru_w_out": nrm((N_LRU_LAYERS, D_RNN, D), DEEPNORM_BETA * D_RNN ** -0.5),
        "conv_w_in": nrm((N_CONV_LAYERS, D, 2 * D), D ** -0.5),
        "conv_b_in": nrm((N_CONV_LAYERS, 2 * D), 0.02),
        "conv_dw_w": nrm((N_CONV_LAYERS, CONV_K, D), CONV_K ** -0.5),
        "conv_dw_b": nrm((N_CONV_LAYERS, D), 0.02),
        "conv_ln_g": gain((N_CONV_LAYERS, D)),
        "conv_ln_b": nrm((N_CONV_LAYERS, D), 0.02),
        "conv_w_out": nrm((N_CONV_LAYERS, D, D), DEEPNORM_BETA * D ** -0.5),
        "conv_b_out": nrm((N_CONV_LAYERS, D), 0.02),
        "moe_router": nrm((DEPTH, D, E), D ** -0.5),
        "moe_w1": nrm((DEPTH, E, D, F), D ** -0.5),
        "moe_w3": nrm((DEPTH, E, D, F), D ** -0.5),
        "moe_w2": nrm((DEPTH, E, F, D), DEEPNORM_BETA * F ** -0.5),
    }


def reference(x, c, ctx, c_ctx, ada_w, ada_b, ln1_g, ln1_b, ln2_g, ln2_b,
              attn_w_qkv, attn_sink, attn_w_o,
              lru_w_in, lru_conv_w, lru_conv_b, lru_gate_a_w, lru_gate_a_b, lru_gate_x_w,
              lru_gate_x_b, lru_lambda, lru_w_out,
              conv_w_in, conv_b_in, conv_dw_w, conv_dw_b, conv_ln_g, conv_ln_b, conv_w_out, conv_b_out,
              moe_router, moe_w1, moe_w3, moe_w2):
    cos, sin = axial_rope_tables(x.shape[1])
    h = ctx
    silu_c = jax.nn.silu(c)
    silu_cc = jax.nn.silu(c_ctx)
    for i in range(DEPTH):
        need_ctx = i < DEPTH - 1
        kind, j = i % N_MIXERS, i // N_MIXERS
        mod = silu_c @ ada_w[i] + ada_b[i]
        mod_c = silu_cc @ ada_w[i] + ada_b[i]
        sh1, sc1, g1, sh2, sc2, g2 = jnp.split(mod[:, None, :], 6, axis=-1)
        csh1, csc1, cg1, csh2, csc2, cg2 = jnp.split(mod_c, 6)
        u = x * (1 + sc1) + sh1
        uc = h * (1 + csc1) + csh1
        if kind == 0:
            y, yc = windowed_sink_gqa(u, uc, attn_w_qkv[j], attn_sink[j], attn_w_o[j], cos, sin, need_ctx)
        elif kind == 1:
            y, yc = rglru_mixer(u, uc, lru_w_in[j], lru_conv_w[j], lru_conv_b[j], lru_gate_a_w[j],
                                lru_gate_a_b[j], lru_gate_x_w[j], lru_gate_x_b[j], lru_lambda[j],
                                lru_w_out[j], need_ctx)
        else:
            y, yc = conformer_conv(u, uc, conv_w_in[j], conv_b_in[j], conv_dw_w[j], conv_dw_b[j],
                                   conv_ln_g[j], conv_ln_b[j], conv_w_out[j], conv_b_out[j], need_ctx)
        x = layer_norm(DEEPNORM_ALPHA * x + g1 * y, ln1_g[i], ln1_b[i])
        f = expert_choice_ffn(x * (1 + sc2) + sh2, moe_router[i], moe_w1[i], moe_w3[i], moe_w2[i])
        x = layer_norm(DEEPNORM_ALPHA * x + g2 * f, ln2_g[i], ln2_b[i])
        if need_ctx:
            h = layer_norm(DEEPNORM_ALPHA * h + cg1 * yc, ln1_g[i], ln1_b[i])
            fc = expert_choice_ffn(h * (1 + csc2) + csh2, moe_router[i], moe_w1[i], moe_w3[i], moe_w2[i])
            h = layer_norm(DEEPNORM_ALPHA * h + cg2 * fc, ln2_g[i], ln2_b[i])
    return x
```

```cpp
#include <hip/hip_runtime.h>
#include <cstdio>
#include <cstdint>

#ifndef MK_ONE_LAUNCH
#define MK_ONE_LAUNCH 0
#endif

#define LAS __attribute__((address_space(3)))
#define DI __device__ __forceinline__
typedef unsigned short bf16_t;
typedef short bf16x8 __attribute__((ext_vector_type(8)));
typedef short s16x4 __attribute__((ext_vector_type(4)));
typedef float f32x2 __attribute__((ext_vector_type(2)));
typedef float f32x4 __attribute__((ext_vector_type(4)));
typedef float f32x16 __attribute__((ext_vector_type(16)));
typedef unsigned u32x2 __attribute__((ext_vector_type(2)));
typedef unsigned u32x4 __attribute__((ext_vector_type(4)));
typedef __bf16 bf16x2_t __attribute__((ext_vector_type(2)));

constexpr int D = 1024, NB = 2, SEQ = 16384, CTXL = 256;
constexpr int NL = NB * SEQ, NC = NB * CTXL, MALL = NL + NC;
constexpr int NE = 16, FF = 2048, CAPL = 2048, CAPC = 32;
constexpr int NSLOT_L = NB * NE * CAPL;
constexpr int NSLOT = NSLOT_L + NE * 256;
constexpr int NCHUNK = 520;
constexpr float ALPHA = 1.681792830507429f;
constexpr float LN_EPS = 1e-5f;
constexpr float LOG2E = 1.4426950408889634f;
constexpr int NTHREADS = 512;
constexpr int LDS_MISC = 131072;
constexpr int LDS_BYTES = LDS_MISC + 1024;

constexpr size_t al4k(size_t x) { return (x + 4095) & ~(size_t)4095; }
constexpr size_t OFF_CTL = 0;
constexpr size_t CTL_BYTES = 65536;
constexpr size_t OFF_MODS = OFF_CTL + CTL_BYTES;
constexpr size_t OFF_SP = OFF_MODS + al4k((size_t)4 * 3 * 6144 * 4);
constexpr size_t OFF_ROPE = OFF_SP + 8192;
constexpr size_t OFF_AFFT = OFF_ROPE + al4k((size_t)16384 * 32 * 8);
constexpr size_t OFF_IDX = OFF_AFFT + al4k((size_t)(2 * 16 * 16384 + 2 * 16 * 256) * 4);
constexpr size_t OFF_GATE = OFF_IDX + al4k((size_t)NSLOT * 4);
constexpr size_t OFF_SLOT = OFF_GATE + al4k((size_t)NSLOT * 4);
constexpr size_t OFF_PQ = OFF_SLOT + al4k((size_t)MALL * 16 * 4);
constexpr size_t OFF_CIN = OFF_PQ + al4k((size_t)2 * NCHUNK * 1024 * 8);
constexpr size_t OFF_X = OFF_CIN + al4k((size_t)2 * NCHUNK * 1024 * 4);
constexpr size_t OFF_U = OFF_X + al4k((size_t)MALL * 1024 * 4);
constexpr size_t OFF_T = OFF_U + al4k((size_t)MALL * 1024 * 2);
constexpr size_t OFF_Z = OFF_T + al4k((size_t)MALL * 1024 * 2);
constexpr size_t OFF_Z2 = OFF_Z + al4k((size_t)MALL * 2048 * 2);
constexpr size_t OFF_Y = OFF_Z2 + al4k((size_t)MALL * 1024 * 2);
constexpr size_t OFF_BIG = OFF_Y + al4k((size_t)MALL * 1024 * 4);
constexpr size_t BIG_BYTES = (size_t)4 * MALL * 1024 * 4;
constexpr size_t OFF_HID = OFF_BIG;
constexpr size_t OFF_YS = OFF_HID + al4k((size_t)NSLOT * 2048 * 2);
static_assert(OFF_YS + (size_t)NSLOT * 1024 * 2 <= OFF_BIG + BIG_BYTES, "big region");
constexpr size_t OFF_WQKV = OFF_BIG + al4k(BIG_BYTES);
constexpr size_t OFF_WO = OFF_WQKV + (size_t)2 * 1536 * 1024 * 2;
constexpr size_t OFF_LWIN = OFF_WO + (size_t)2 * 1024 * 1024 * 2;
constexpr size_t OFF_LGATE = OFF_LWIN + (size_t)2048 * 1024 * 2;
constexpr size_t OFF_LWOUT = OFF_LGATE + (size_t)8 * 512 * 256 * 2;
constexpr size_t OFF_CWIN = OFF_LWOUT + (size_t)1024 * 1024 * 2;
constexpr size_t OFF_CWOUT = OFF_CWIN + (size_t)2048 * 1024 * 2;
constexpr size_t OFF_WMOE = OFF_CWOUT + (size_t)1024 * 1024 * 2;
constexpr size_t MOE_E_ELEMS = (size_t)6 * 1024 * 1024;
constexpr size_t WS_TOTAL = OFF_WMOE + (size_t)64 * MOE_E_ELEMS * 2;

struct Params { const float* in[34]; float* out; char* ws; int ph_lo, ph_hi; };

enum { I_X = 0, I_C, I_CTX, I_CCTX, I_ADAW, I_ADAB, I_LN1G, I_LN1B, I_LN2G, I_LN2B, I_WQKV, I_SINK, I_WO, I_LWIN, I_LCW, I_LCB, I_LGAW, I_LGAB, I_LGXW, I_LGXB,
       I_LLAM, I_LWOUT, I_CWIN, I_CBIN, I_CDW, I_CDB, I_CLNG, I_CLNB, I_CWOUT, I_CBOUT, I_ROUTER, I_W1, I_W3, I_W2 };

DI unsigned pk_bf16(float lo, float hi) { f32x2 v = {lo, hi}; bf16x2_t b = __builtin_convertvector(v, bf16x2_t); return __builtin_bit_cast(unsigned, b); }
DI float bflo(unsigned w) { return __uint_as_float(w << 16); }
DI float bfhi(unsigned w) { return __uint_as_float(w & 0xffff0000u); }
DI float bf2f(bf16_t b) { return __uint_as_float((unsigned)b << 16); }
DI int otid() { int t = threadIdx.x; asm volatile("" : "+v"(t)); return t; }
DI float wave_sum(float v) {
#pragma unroll
    for (int o = 1; o < 64; o <<= 1) v += __shfl_xor(v, o);
    return v;
}
DI float sigmoidf_(float x) { return 1.0f / (1.0f + __expf(-x)); }
DI float siluf_(float x) { return x / (1.0f + __expf(-x)); }
DI float gelu_tanh(float x) { const float u = 0.7978845608028654f * (x + 0.044715f * x * x * x); const float t = 1.0f - 2.0f / (__expf(2.0f * u) + 1.0f); return 0.5f * x * (1.0f + t); }
DI int mod_of_row(int r) { return r < SEQ ? 0 : (r < NL ? 1 : 2); }
DI const float* mods_ptr(const Params& p, int L, int m, int which) { return (const float*)(p.ws + OFF_MODS) + ((size_t)(L * 3 + m) * 6 + which) * 1024; }

#define XB_TMO      128
#define XB_XCNT(j)  (256  + 64 * (j))
#define XB_XSUB(j)  (1280 + 64 * (j))
#define XB_XGEN(j)  (2304 + 64 * (j))
#define XB_TOP      3328
#define XB_TOPGEN   3392
#define XCD_BAR_WORDS 3456
#define XB_SPIN_CAP (1u << 22)
DI unsigned xb_ld(unsigned* p)              { return __hip_atomic_load(p, __ATOMIC_RELAXED, __HIP_MEMORY_SCOPE_AGENT); }
DI unsigned xb_add(unsigned* p, unsigned v) { return __hip_atomic_fetch_add(p, v, __ATOMIC_RELAXED, __HIP_MEMORY_SCOPE_AGENT); }
DI unsigned xb_xcc_id() { return (unsigned)__builtin_amdgcn_s_getreg((3 << 11) | 20) & 0xFu; }
#define XB_SPIN(cond, bar) do { unsigned _sp = 0; while (cond) { __builtin_amdgcn_s_sleep(1); \
    if ((++_sp & 255u) == 0u) { if (xb_ld(&(bar)[XB_TMO])) break; if (_sp > XB_SPIN_CAP) { atomicAdd(&(bar)[XB_TMO], 1u); break; } } } } while (0)
struct XcdBarrier { unsigned* bar; unsigned x; volatile LAS unsigned* st; };
DI XcdBarrier xcd_barrier_post(unsigned* bar, volatile LAS unsigned* st) {
    XcdBarrier b; b.bar = bar; b.x = xb_xcc_id(); b.st = st;
    if (threadIdx.x == 0) (void)xb_add(&bar[XB_XCNT(b.x)], 1u);
    return b;
}
DI void xcd_barrier_complete(unsigned* bar, unsigned x, unsigned& nloc, unsigned& nx) {
    const unsigned G = gridDim.x * gridDim.y * gridDim.z;
    unsigned sum, cnt, mine, sp = 0u;
    for (;;) {
        sum = 0u; cnt = 0u; mine = 0u;
#pragma unroll
        for (unsigned j = 0; j < 16; ++j) { const unsigned c = xb_ld(&bar[XB_XCNT(j)]); sum += c; cnt += (c > 0u) ? 1u : 0u; mine = (j == x) ? c : mine; }
        if (sum == G) break;
        __builtin_amdgcn_s_sleep(1);
        if ((++sp & 255u) == 0u) { if (xb_ld(&bar[XB_TMO])) break; if (sp > XB_SPIN_CAP) { atomicAdd(&bar[XB_TMO], 1u); break; } }
    }
    nloc = mine > 0u ? mine : 1u; nx = cnt > 0u ? cnt : 1u;
}
DI void xcd_barrier(const XcdBarrier& b) {
    asm volatile("s_waitcnt vmcnt(0)" ::: "memory");
    __syncthreads();
    if (threadIdx.x == 0) {
        unsigned* bar = b.bar;
        __builtin_amdgcn_s_waitcnt(0);
        unsigned nloc = b.st[0], nx = b.st[1];
        if (nloc == 0u) { xcd_barrier_complete(bar, b.x, nloc, nx); b.st[0] = nloc; b.st[1] = nx; }
        const unsigned old = xb_add(&bar[XB_XSUB(b.x)], 1u);
        const unsigned gen = old / nloc;
        if (old + 1u == (gen + 1u) * nloc) {
            __builtin_amdgcn_fence(__ATOMIC_RELEASE, "agent");
            asm volatile("s_waitcnt vmcnt(0)" ::: "memory");
            const unsigned og = xb_add(&bar[XB_TOP], 1u);
            const unsigned tg = og / nx;
            if (og + 1u == (tg + 1u) * nx) xb_add(&bar[XB_TOPGEN], 1u);
            else XB_SPIN(xb_ld(&bar[XB_TOPGEN]) == tg, bar);
            __builtin_amdgcn_fence(__ATOMIC_ACQUIRE, "agent");
            xb_add(&bar[XB_XGEN(b.x)], 1u);
            asm volatile("s_waitcnt vmcnt(0)" ::: "memory");
        } else {
            XB_SPIN(xb_ld(&bar[XB_XGEN(b.x)]) == gen, bar);
            __builtin_amdgcn_fence(__ATOMIC_ACQUIRE, "agent");
            asm volatile("s_waitcnt vmcnt(0)" ::: "memory");
        }
    }
    __syncthreads();
}

struct GUnit { const bf16_t* A; const int* idx; const bf16_t* B; int arow0, lda, K, orow0, ocol0, aux; };

template <class Sched, class Epi>
DI void gemm_simple(LAS char* lds, const Sched& S, const Epi& E) {
    const int tid = otid(), wid = tid >> 6, lane = tid & 63, wr = wid >> 2, wc = wid & 3, fr = lane & 15, fq = lane >> 4;
    for (int ui = blockIdx.x; ui < S.n; ui += gridDim.x) {
        GUnit u; S.get(ui, u);
        f32x4 acc[2][2][4][2];
#pragma unroll
        for (int a = 0; a < 2; ++a)
#pragma unroll
            for (int b = 0; b < 2; ++b)
#pragma unroll
                for (int m = 0; m < 4; ++m)
#pragma unroll
                    for (int n = 0; n < 2; ++n) acc[a][b][m][n] = (f32x4){0.f, 0.f, 0.f, 0.f};
        const bf16_t* ap[2]; const bf16_t* bp[2]; int lo[2];
#pragma unroll
        for (int i = 0; i < 2; ++i) {
            const int c = tid + 512 * i, row = c >> 2, kc = c & 3;
            const int grow = u.idx ? u.idx[row] : (u.arow0 + row);
            ap[i] = u.A + (size_t)grow * u.lda + kc * 8; bp[i] = u.B + (size_t)row * u.K + kc * 8; lo[i] = row * 80 + kc * 16;
        }
        for (int k0 = 0; k0 < u.K; k0 += 32) {
            const u32x4 a0 = *(const u32x4*)(ap[0] + k0), a1 = *(const u32x4*)(ap[1] + k0), b0 = *(const u32x4*)(bp[0] + k0), b1 = *(const u32x4*)(bp[1] + k0);
            __syncthreads();
            *(LAS u32x4*)(lds + lo[0]) = a0; *(LAS u32x4*)(lds + lo[1]) = a1;
            *(LAS u32x4*)(lds + 20480 + lo[0]) = b0; *(LAS u32x4*)(lds + 20480 + lo[1]) = b1;
            __syncthreads();
            bf16x8 Af[2][4], Bf[2][2];
#pragma unroll
            for (int ai = 0; ai < 2; ++ai)
#pragma unroll
                for (int m = 0; m < 4; ++m) Af[ai][m] = *(const LAS bf16x8*)(lds + (ai * 128 + wr * 64 + m * 16 + fr) * 80 + fq * 16);
#pragma unroll
            for (int bj = 0; bj < 2; ++bj)
#pragma unroll
                for (int n = 0; n < 2; ++n) Bf[bj][n] = *(const LAS bf16x8*)(lds + 20480 + (bj * 128 + wc * 32 + n * 16 + fr) * 80 + fq * 16);
#pragma unroll
            for (int ai = 0; ai < 2; ++ai)
#pragma unroll
                for (int bj = 0; bj < 2; ++bj)
#pragma unroll
                    for (int m = 0; m < 4; ++m)
#pragma unroll
                        for (int n = 0; n < 2; ++n) acc[ai][bj][m][n] = __builtin_amdgcn_mfma_f32_16x16x32_bf16(Bf[bj][n], Af[ai][m], acc[ai][bj][m][n], 0, 0, 0);
        }
        E(acc, u, wr, wc, fr, fq);
    }
    __syncthreads();
}
#define GEMM_PHASE gemm_simple

struct SchedDense {
    const bf16_t* A; const bf16_t* Bt; int lda, K, ntn, n;
    DI void get(int ui, GUnit& u) const { const int pm = ui / ntn, pn = ui - pm * ntn;
        u.A = A; u.idx = nullptr; u.arow0 = pm * 256; u.lda = lda; u.K = K; u.B = Bt + (size_t)pn * 256 * K; u.orow0 = pm * 256; u.ocol0 = pn * 256; u.aux = pn; }
};
struct SchedGates {
    const bf16_t* A; const bf16_t* Bt; int n;
    DI void get(int ui, GUnit& u) const { const int pm = ui >> 4, q = ui & 15, dir = q >> 3, blk = (q >> 1) & 3, half = q & 1;
        u.A = A + blk * 256; u.idx = nullptr; u.arow0 = pm * 256; u.lda = 1024; u.K = 256; u.B = Bt + ((size_t)((dir * 4 + blk) * 512 + half * 256)) * 256;
        u.orow0 = pm * 256; u.ocol0 = blk * 256 + half * 128; u.aux = dir; }
};
struct SchedMoe1 {
    const bf16_t* T; const int* idx; const bf16_t* W; int n;
    DI void get(int ui, GUnit& u) const {
        int e, nt, srow;
        if (ui < 4096) { const int grp = ui >> 7, mt = (ui >> 4) & 7; nt = ui & 15; e = grp & 15; srow = grp * 2048 + mt * 256; }
        else { const int v = ui - 4096; e = v >> 4; nt = v & 15; srow = NSLOT_L + e * 256; }
        u.A = T; u.idx = idx + srow; u.arow0 = 0; u.lda = 1024; u.K = 1024; u.B = W + (size_t)e * MOE_E_ELEMS + (size_t)nt * 256 * 1024; u.orow0 = srow; u.ocol0 = nt * 128; u.aux = e; }
};
struct SchedMoe2 {
    const bf16_t* H; const bf16_t* W; int n;
    DI void get(int ui, GUnit& u) const {
        int e, nt, srow;
        if (ui < 1024) { const int grp = ui >> 5, mt = (ui >> 2) & 7; nt = ui & 3; e = grp & 15; srow = grp * 2048 + mt * 256; }
        else { const int v = ui - 1024; e = v >> 2; nt = v & 3; srow = NSLOT_L + e * 256; }
        u.A = H; u.idx = nullptr; u.arow0 = srow; u.lda = 2048; u.K = 2048; u.B = W + (size_t)e * MOE_E_ELEMS + (size_t)4096 * 1024 + (size_t)nt * 256 * 2048; u.orow0 = srow; u.ocol0 = nt * 256; u.aux = e; }
};

#define EPI_FOR_ROWS _Pragma("unroll") for (int ai = 0; ai < 2; ++ai) _Pragma("unroll") for (int m = 0; m < 4; ++m)
#define EPI_FOR_COLS _Pragma("unroll") for (int bj = 0; bj < 2; ++bj) _Pragma("unroll") for (int n = 0; n < 2; ++n)
typedef f32x4 AccT[2][2][4][2];

struct EpiF32 {
    float* C; const float* bias;
    DI void operator()(const AccT& acc, const GUnit& u, int wr, int wc, int fr, int fq) const {
        EPI_FOR_ROWS { const int row = u.orow0 + ai * 128 + wr * 64 + m * 16 + fr;
            EPI_FOR_COLS { const int col = u.ocol0 + bj * 128 + wc * 32 + n * 16 + 4 * fq; f32x4 v = acc[ai][bj][m][n];
                if (bias) v += *(const f32x4*)(bias + col);
                *(f32x4*)(C + (size_t)row * 1024 + col) = v; } }
    }
};
struct EpiQkv {
    bf16_t* Z; const float* rope;
    DI void operator()(const AccT& acc, const GUnit& u, int wr, int wc, int fr, int fq) const {
        const int kind = u.ocol0 < 1024 ? 0 : (u.ocol0 < 1280 ? 1 : 2);
        EPI_FOR_ROWS { const int row = u.orow0 + ai * 128 + wr * 64 + m * 16 + fr; const bool lat = row < NL; const int pos = row & (SEQ - 1);
            EPI_FOR_COLS { const int col = u.ocol0 + bj * 128 + wc * 32 + n * 16 + 4 * fq; f32x4 v = acc[ai][bj][m][n];
                if (kind < 2 && lat) { const int pi = (col & 63) >> 1; const f32x4 cs = *(const f32x4*)(rope + ((size_t)pos * 32 + pi) * 2);
                    const float a0 = v[0] * cs[0] - v[1] * cs[1], a1 = v[1] * cs[0] + v[0] * cs[1], a2 = v[2] * cs[2] - v[3] * cs[3], a3 = v[3] * cs[2] + v[2] * cs[3];
                    v = (f32x4){a0, a1, a2, a3}; }
                if (kind == 0) v *= 0.125f;
                u32x2 w; w.x = pk_bf16(v[0], v[1]); w.y = pk_bf16(v[2], v[3]);
                *(u32x2*)(Z + (size_t)row * 1536 + col) = w; } }
    }
};
struct EpiLruIn {
    bf16_t* Z;
    DI void operator()(const AccT& acc, const GUnit& u, int wr, int wc, int fr, int fq) const {
        const bool isg = u.ocol0 < 1024;
        EPI_FOR_ROWS { const int row = u.orow0 + ai * 128 + wr * 64 + m * 16 + fr;
            EPI_FOR_COLS { const int col = u.ocol0 + bj * 128 + wc * 32 + n * 16 + 4 * fq; f32x4 v = acc[ai][bj][m][n];
                if (isg) { v[0] = gelu_tanh(v[0]); v[1] = gelu_tanh(v[1]); v[2] = gelu_tanh(v[2]); v[3] = gelu_tanh(v[3]); }
                u32x2 w; w.x = pk_bf16(v[0], v[1]); w.y = pk_bf16(v[2], v[3]);
                *(u32x2*)(Z + (size_t)row * 2048 + col) = w; } }
    }
};
struct EpiGates {
    float* AC; float* BC; const bf16_t* XR; const float* ab; const float* xb; const float* lam;
    DI void operator()(const AccT& acc, const GUnit& u, int wr, int wc, int fr, int fq) const {
        const int dir = u.aux;
        EPI_FOR_ROWS { const int row = u.orow0 + ai * 128 + wr * 64 + m * 16 + fr;
            bool reset = false; if (row >= NL) { const int pos = (row - NL) & 255; reset = (dir == 0) ? (pos == 0) : (pos == 255); }
#pragma unroll
            for (int n = 0; n < 2; ++n) { const int ch = u.ocol0 + wc * 32 + n * 16 + 4 * fq;
                const f32x4 va = acc[ai][0][m][n] + *(const f32x4*)(ab + dir * 1024 + ch), vx = acc[ai][1][m][n] + *(const f32x4*)(xb + dir * 1024 + ch);
                const f32x4 lm = *(const f32x4*)(lam + dir * 1024 + ch); const u32x2 xw = *(const u32x2*)(XR + (size_t)row * 1024 + ch);
                const float xr[4] = {bflo(xw.x), bfhi(xw.x), bflo(xw.y), bfhi(xw.y)};
                f32x4 oa, ob;
#pragma unroll
                for (int j = 0; j < 4; ++j) { const float r = sigmoidf_(va[j]), ig = sigmoidf_(vx[j]);
                    const float la = -r * lm[j]; const float a = __expf(la); const float x2 = 2.0f * la;
                    const float om = (x2 > -0.3f) ? -(x2 * (1.0f + x2 * (0.5f + x2 * (0.16666667f + x2 * (0.041666668f + x2 * (0.008333334f + x2 * (0.0013888889f + x2 * 0.0001984127f))))))) : (1.0f - __expf(x2));
                    float mult = sqrtf(om); if (reset) mult = 1.0f;
                    oa[j] = a; ob[j] = mult * ig * xr[j]; }
                const size_t o = ((size_t)dir * MALL + row) * 1024 + ch;
                *(f32x4*)(AC + o) = oa; *(f32x4*)(BC + o) = ob; asm volatile("" ::: "memory"); } }
    }
};
struct EpiGlu {
    bf16_t* Z; const float* bias;
    DI void operator()(const AccT& acc, const GUnit& u, int wr, int wc, int fr, int fq) const {
        const int cb = u.aux * 128;
        EPI_FOR_ROWS { const int row = u.orow0 + ai * 128 + wr * 64 + m * 16 + fr;
#pragma unroll
            for (int n = 0; n < 2; ++n) { const int ch = cb + wc * 32 + n * 16 + 4 * fq;
                const f32x4 v = acc[ai][0][m][n] + *(const f32x4*)(bias + ch), g = acc[ai][1][m][n] + *(const f32x4*)(bias + 1024 + ch);
                u32x2 w; w.x = pk_bf16(v[0] * sigmoidf_(g[0]), v[1] * sigmoidf_(g[1])); w.y = pk_bf16(v[2] * sigmoidf_(g[2]), v[3] * sigmoidf_(g[3]));
                *(u32x2*)(Z + (size_t)row * 1024 + ch) = w; } }
    }
};
struct EpiSwiglu {
    bf16_t* H;
    DI void operator()(const AccT& acc, const GUnit& u, int wr, int wc, int fr, int fq) const {
        EPI_FOR_ROWS { const int row = u.orow0 + ai * 128 + wr * 64 + m * 16 + fr;
#pragma unroll
            for (int n = 0; n < 2; ++n) { const int ch = u.ocol0 + wc * 32 + n * 16 + 4 * fq; const f32x4 a = acc[ai][0][m][n], b = acc[ai][1][m][n];
                u32x2 w; w.x = pk_bf16(siluf_(a[0]) * b[0], siluf_(a[1]) * b[1]); w.y = pk_bf16(siluf_(a[2]) * b[2], siluf_(a[3]) * b[3]);
                *(u32x2*)(H + (size_t)row * 2048 + ch) = w; } }
    }
};
struct EpiMoeOut {
    bf16_t* YS; const float* gate;
    DI void operator()(const AccT& acc, const GUnit& u, int wr, int wc, int fr, int fq) const {
        EPI_FOR_ROWS { const int row = u.orow0 + ai * 128 + wr * 64 + m * 16 + fr; const float g = gate[row];
            EPI_FOR_COLS { const int col = u.ocol0 + bj * 128 + wc * 32 + n * 16 + 4 * fq; const f32x4 v = acc[ai][bj][m][n] * g;
                u32x2 w; w.x = pk_bf16(v[0], v[1]); w.y = pk_bf16(v[2], v[3]);
                *(u32x2*)(YS + (size_t)row * 1024 + col) = w; } }
    }
};

struct CvtJob { const float* srcA; const float* srcB; bf16_t* dst; int ld, K, mode; };
DI bool small_job(const Params& p, int t, CvtJob& J, int& tile) {
    int j;
    if (t < 384) j = 0; else if (t < 768) { j = 1; t -= 384; } else if (t < 1024) { j = 2; t -= 768; } else if (t < 1280) { j = 3; t -= 1024; } else if (t < 1792) { j = 4; t -= 1280; }
    else if (t < 2048) { j = 5 + ((t - 1792) >> 5); t = (t - 1792) & 31; } else if (t < 2304) { j = 13; t -= 2048; } else if (t < 2816) { j = 14; t -= 2304; } else if (t < 3072) { j = 15; t -= 2816; } else return false;
    tile = t; J.srcB = nullptr; J.mode = 0;
    if (j < 2) { J.srcA = p.in[I_WQKV] + (size_t)j * 1024 * 1536; J.dst = (bf16_t*)(p.ws + OFF_WQKV) + (size_t)j * 1536 * 1024; J.ld = 1536; J.K = 1024; J.mode = 1; }
    else if (j < 4) { J.srcA = p.in[I_WO] + (size_t)(j - 2) * 1024 * 1024; J.dst = (bf16_t*)(p.ws + OFF_WO) + (size_t)(j - 2) * 1024 * 1024; J.ld = 1024; J.K = 1024; }
    else if (j == 4) { J.srcA = p.in[I_LWIN]; J.dst = (bf16_t*)(p.ws + OFF_LWIN); J.ld = 2048; J.K = 1024; }
    else if (j < 13) { const int q = j - 5; J.srcA = p.in[I_LGAW] + (size_t)q * 65536; J.srcB = p.in[I_LGXW] + (size_t)q * 65536; J.dst = (bf16_t*)(p.ws + OFF_LGATE) + (size_t)q * 512 * 256; J.ld = 256; J.K = 256; J.mode = 2; }
    else if (j == 13) { J.srcA = p.in[I_LWOUT]; J.dst = (bf16_t*)(p.ws + OFF_LWOUT); J.ld = 1024; J.K = 1024; }
    else if (j == 14) { J.srcA = p.in[I_CWIN]; J.srcB = p.in[I_CWIN] + 1024; J.dst = (bf16_t*)(p.ws + OFF_CWIN); J.ld = 2048; J.K = 1024; J.mode = 2; }
    else { J.srcA = p.in[I_CWOUT]; J.dst = (bf16_t*)(p.ws + OFF_CWOUT); J.ld = 1024; J.K = 1024; }
    return true;
}
constexpr int SMALL_TILES = 384 * 2 + 256 * 2 + 512 + 32 * 8 + 256 + 512 + 256;
constexpr int MOE_TILES_E = 1024 + 512;
constexpr int CVT_TILES = SMALL_TILES + 64 * MOE_TILES_E;

DI void cvt_tile(const CvtJob& J, int tile, LAS float* scr) {
    const int tid = otid(); const int nk = J.K >> 6; const int rt = tile / nk, kt = tile - rt * nk, r0 = rt * 64, k0 = kt * 64;
    { const int c = tid & 63, kq = tid >> 6; const int r = r0 + c; const float* src = J.srcA; int col = r;
      if (J.mode == 1) { if (r < 1280) { const int h = r >> 6, pp = r & 63; col = (h << 6) + (pp >> 1) + ((pp & 1) << 5); } }
      else if (J.mode == 2) { const int blk = r >> 8, t = r & 255; col = blk * 128 + (t & 127); if (t >> 7) src = J.srcB; }
      src += col;
#pragma unroll
      for (int j = 0; j < 8; ++j) { const int kk = kq * 8 + j; scr[kk * 65 + c] = src[(size_t)(k0 + kk) * J.ld]; } }
    __syncthreads();
    { const int rr = tid >> 3, kc = tid & 7; const LAS float* s = scr + (kc * 8) * 65 + rr;
      u32x4 o; o.x = pk_bf16(s[0], s[65]); o.y = pk_bf16(s[2 * 65], s[3 * 65]); o.z = pk_bf16(s[4 * 65], s[5 * 65]); o.w = pk_bf16(s[6 * 65], s[7 * 65]);
      *(u32x4*)(J.dst + (size_t)(r0 + rr) * J.K + k0 + kc * 8) = o; }
    __syncthreads();
}

DI void phase_prologue(const Params& p, LAS char* lds) {
    const int tid = otid();
    LAS float* sil = (LAS float*)lds;
    LAS float* red = sil + 3 * 1024;
    if (blockIdx.x < 192) {
        for (int i = tid; i < 3 * 1024; i += NTHREADS) { const int m = i >> 10, k = i & 1023; const float c = (m < 2) ? p.in[I_C][m * 1024 + k] : p.in[I_CCTX][k]; sil[i] = siluf_(c); }
        __syncthreads();
        for (int item = blockIdx.x; item < 192; item += gridDim.x) {
            const int L = item / 48, j0 = (item % 48) * 128, c = tid & 127, kq = tid >> 7;
            const float* W = p.in[I_ADAW] + (size_t)L * 1024 * 6144 + j0 + c;
            float a0 = 0.f, a1 = 0.f, a2 = 0.f;
#pragma unroll 8
            for (int k = kq * 256; k < kq * 256 + 256; ++k) { const float w = W[(size_t)k * 6144]; a0 += sil[k] * w; a1 += sil[1024 + k] * w; a2 += sil[2048 + k] * w; }
            red[(kq * 3 + 0) * 128 + c] = a0; red[(kq * 3 + 1) * 128 + c] = a1; red[(kq * 3 + 2) * 128 + c] = a2;
            __syncthreads();
            if (tid < 384) { const int m = tid >> 7, cc = tid & 127; const float s = red[(0 * 3 + m) * 128 + cc] + red[(1 * 3 + m) * 128 + cc] + red[(2 * 3 + m) * 128 + cc] + red[(3 * 3 + m) * 128 + cc];
                ((float*)(p.ws + OFF_MODS))[(size_t)(L * 3 + m) * 6144 + j0 + cc] = s + p.in[I_ADAB][L * 6144 + j0 + cc]; }
            __syncthreads();
        }
    }
    for (int i = blockIdx.x * NTHREADS + tid; i < 16384 * 32; i += gridDim.x * NTHREADS) {
        const int pos = i >> 5, fi = i & 31; const int rc = (fi < 16) ? (pos >> 6) : (pos & 63);
        const float inv = (float)pow(10000.0, -(double)(fi & 15) / 16.0); const float ang = (float)rc * inv;
        f32x2 cs; cs.x = (float)cos((double)ang); cs.y = (float)sin((double)ang);
        ((f32x2*)(p.ws + OFF_ROPE))[i] = cs;
    }
    if (blockIdx.x == gridDim.x - 1) for (int i = tid; i < 2048; i += NTHREADS) ((float*)(p.ws + OFF_SP))[i] = 8.0f * log1pf(expf(-p.in[I_LLAM][i]));
    __syncthreads();
    for (int t = blockIdx.x; t < CVT_TILES; t += gridDim.x) {
        CvtJob J; int tile;
        if (t < SMALL_TILES) { small_job(p, t, J, tile); }
        else { const int v = t - SMALL_TILES; const int me = v / MOE_TILES_E; int r = v - me * MOE_TILES_E; bf16_t* dst = (bf16_t*)(p.ws + OFF_WMOE) + (size_t)me * MOE_E_ELEMS;
            if (r < 1024) { J.srcA = p.in[I_W1] + (size_t)me * 1024 * 2048; J.srcB = p.in[I_W3] + (size_t)me * 1024 * 2048; J.dst = dst; J.ld = 2048; J.K = 1024; J.mode = 2; tile = r; }
            else { J.srcA = p.in[I_W2] + (size_t)me * 2048 * 1024; J.srcB = nullptr; J.dst = dst + (size_t)4096 * 1024; J.ld = 1024; J.K = 2048; J.mode = 0; tile = r - 1024; } }
        cvt_tile(J, tile, (LAS float*)lds);
    }
}

DI void phase_init(const Params& p) {
    const int tid = otid(); const int wid = tid >> 6, lane = tid & 63;
    float* X = (float*)(p.ws + OFF_X); bf16_t* U = (bf16_t*)(p.ws + OFF_U);
    for (int r = blockIdx.x * 8 + wid; r < MALL; r += gridDim.x * 8) {
        const float* src = (r < NL) ? p.in[I_X] + (size_t)r * 1024 : p.in[I_CTX] + (size_t)(r - NL) * 1024;
        const int mm = mod_of_row(r); const float* sh = mods_ptr(p, 0, mm, 0); const float* sc = mods_ptr(p, 0, mm, 1);
#pragma unroll
        for (int i = 0; i < 4; ++i) { const int c = i * 256 + lane * 4; const f32x4 v = *(const f32x4*)(src + c);
            *(f32x4*)(X + (size_t)r * 1024 + c) = v;
            const f32x4 s1 = *(const f32x4*)(sc + c), h1 = *(const f32x4*)(sh + c); const f32x4 t = v * (1.0f + s1) + h1;
            u32x2 w; w.x = pk_bf16(t[0], t[1]); w.y = pk_bf16(t[2], t[3]); *(u32x2*)(U + (size_t)r * 1024 + c) = w; }
    }
}

DI void phase_ln1(const Params& p, int L, bool need_ctx, LAS char* lds) {
    const int tid = otid(), wid = tid >> 6, lane = tid & 63;
    LAS float* rt = (LAS float*)lds;
    { const float* R = p.in[I_ROUTER] + (size_t)L * 1024 * 16; for (int i = tid; i < 4096; i += NTHREADS) ((LAS f32x4*)rt)[i] = ((const f32x4*)R)[i]; }
    __syncthreads();
    float* X = (float*)(p.ws + OFF_X); const float* Y = (const float*)(p.ws + OFF_Y); bf16_t* T = (bf16_t*)(p.ws + OFF_T); float* AFFT = (float*)(p.ws + OFF_AFFT);
    const float* lg = p.in[I_LN1G] + L * 1024; const float* lb = p.in[I_LN1B] + L * 1024;
    const int nrows = need_ctx ? MALL : NL;
    for (int r = blockIdx.x * 8 + wid; r < nrows; r += gridDim.x * 8) {
        const int mm = mod_of_row(r); const float* g1 = mods_ptr(p, L, mm, 2); const float* sh2 = mods_ptr(p, L, mm, 3); const float* sc2 = mods_ptr(p, L, mm, 4);
        f32x4 v[4]; float s = 0.f;
#pragma unroll
        for (int i = 0; i < 4; ++i) { const int c = i * 256 + lane * 4; const f32x4 x = *(const f32x4*)(X + (size_t)r * 1024 + c), y = *(const f32x4*)(Y + (size_t)r * 1024 + c), g = *(const f32x4*)(g1 + c);
            v[i] = ALPHA * x + g * y; s += (v[i][0] + v[i][1]) + (v[i][2] + v[i][3]); }
        const float mean = wave_sum(s) * (1.0f / 1024.0f); float q = 0.f;
#pragma unroll
        for (int i = 0; i < 4; ++i) { v[i] = v[i] - mean; q += (v[i][0] * v[i][0] + v[i][1] * v[i][1]) + (v[i][2] * v[i][2] + v[i][3] * v[i][3]); }
        const float rstd = 1.0f / sqrtf(wave_sum(q) * (1.0f / 1024.0f) + LN_EPS);
        float part[16];
#pragma unroll
        for (int e = 0; e < 16; ++e) part[e] = 0.f;
#pragma unroll
        for (int i = 0; i < 4; ++i) { const int c = i * 256 + lane * 4; const f32x4 x1 = v[i] * rstd * *(const f32x4*)(lg + c) + *(const f32x4*)(lb + c);
            *(f32x4*)(X + (size_t)r * 1024 + c) = x1;
            const f32x4 t = x1 * (1.0f + *(const f32x4*)(sc2 + c)) + *(const f32x4*)(sh2 + c);
            u32x2 w; w.x = pk_bf16(t[0], t[1]); w.y = pk_bf16(t[2], t[3]); *(u32x2*)(T + (size_t)r * 1024 + c) = w;
            v[i] = t; }
#pragma unroll
        for (int i = 0; i < 4; ++i) { const int c = i * 256 + lane * 4;
#pragma unroll
            for (int j = 0; j < 4; ++j) { const LAS f32x4* rr = (const LAS f32x4*)(rt + (c + j) * 16); const float tj = v[i][j];
#pragma unroll
                for (int e4 = 0; e4 < 4; ++e4) { const f32x4 w4 = rr[e4]; part[e4 * 4 + 0] += tj * w4[0]; part[e4 * 4 + 1] += tj * w4[1]; part[e4 * 4 + 2] += tj * w4[2]; part[e4 * 4 + 3] += tj * w4[3]; } }
            asm volatile("" ::: "memory"); }
        float mx = -3.0e38f;
#pragma unroll
        for (int e = 0; e < 16; ++e) { part[e] = wave_sum(part[e]); mx = fmaxf(mx, part[e]); }
        float den = 0.f;
#pragma unroll
        for (int e = 0; e < 16; ++e) { part[e] = expf(part[e] - mx); den += part[e]; }
        const float inv = 1.0f / den; float mine = 0.f;
#pragma unroll
        for (int e = 0; e < 16; ++e) mine = (lane == e) ? part[e] * inv : mine;
        if (lane < 16) { size_t o;
            if (r < NL) { const int b = r >> 14, n = r & (SEQ - 1); o = ((size_t)(b * 16 + lane)) * SEQ + n; }
            else { const int q2 = r - NL, b = q2 >> 8, n = q2 & 255; o = (size_t)2 * 16 * SEQ + ((size_t)(b * 16 + lane)) * 256 + n; }
            AFFT[o] = mine; }
    }
    __syncthreads();
}

DI void phase_topk(const Params& p, bool need_ctx, LAS char* lds) {
    const int tid = otid(), wid = tid >> 6, lane = tid & 63;
    LAS unsigned* keys = (LAS unsigned*)lds; LAS unsigned* hist = keys + 16384; LAS unsigned* misc = hist + 256;
    const float* AFFT = (const float*)(p.ws + OFF_AFFT); int* IDX = (int*)(p.ws + OFF_IDX); float* GATE = (float*)(p.ws + OFF_GATE); int* SLOT = (int*)(p.ws + OFF_SLOT);
    const int ngroups = need_ctx ? 64 : 32;
    for (int g = blockIdx.x; g < ngroups; g += gridDim.x) {
        int n, cap, rowbase, slotbase, e; const float* aff;
        if (g < 32) { const int b = g >> 4; e = g & 15; n = SEQ; cap = CAPL; rowbase = b * SEQ; slotbase = g * 2048; aff = AFFT + (size_t)g * SEQ; }
        else { const int v = g - 32, b = v >> 4; e = v & 15; n = 256; cap = CAPC; rowbase = NL + b * 256; slotbase = NSLOT_L + e * 256 + b * 32; aff = AFFT + (size_t)2 * 16 * SEQ + (size_t)v * 256;
            if (b == 0 && tid < 192) { IDX[NSLOT_L + e * 256 + 64 + tid] = NL; GATE[NSLOT_L + e * 256 + 64 + tid] = 0.f; } }
        for (int i = tid; i < n; i += NTHREADS) keys[i] = __float_as_uint(aff[i]);
        __syncthreads();
        unsigned prefix = 0u, remaining = (unsigned)cap;
        for (int pass = 0; pass < 4; ++pass) {
            const int shift = 24 - 8 * pass;
            if (tid < 256) hist[tid] = 0u;
            __syncthreads();
            for (int i = tid; i < n; i += NTHREADS) { const unsigned k = keys[i]; if (pass == 0 || (k >> (shift + 8)) == prefix) __hip_atomic_fetch_add(&hist[(k >> shift) & 255u], 1u, __ATOMIC_RELAXED, __HIP_MEMORY_SCOPE_WORKGROUP); }
            __syncthreads();
            if (wid == 0) {
                const int b3 = 255 - 4 * lane; const unsigned c0 = hist[b3], c1 = hist[b3 - 1], c2 = hist[b3 - 2], c3 = hist[b3 - 3]; const unsigned s = c0 + c1 + c2 + c3;
                unsigned inc = s;
#pragma unroll
                for (int o = 1; o < 64; o <<= 1) { const unsigned t = __shfl_up(inc, o); if (lane >= o) inc += t; }
                const unsigned long long mask = __ballot(inc >= remaining); const int fl = __ffsll((long long)mask) - 1;
                if (lane == fl) { unsigned cum = inc - s; int bin;
                    if (cum + c0 >= remaining) bin = b3; else { cum += c0; if (cum + c1 >= remaining) bin = b3 - 1; else { cum += c1; if (cum + c2 >= remaining) bin = b3 - 2; else { cum += c2; bin = b3 - 3; } } }
                    misc[0] = (unsigned)bin; misc[1] = remaining - cum; }
            }
            __syncthreads();
            prefix = (prefix << 8) | misc[0]; remaining = misc[1];
            __syncthreads();
        }
        const unsigned thr = prefix, need_eq = remaining;
        const int per = (n >= NTHREADS) ? n / NTHREADS : 1; const int nact = n / per;
        unsigned gt = 0u, eq = 0u;
        if (tid < nact) for (int j = 0; j < per; ++j) { const unsigned k = keys[tid * per + j]; gt += (k > thr); eq += (k == thr); }
        const unsigned packed = gt | (eq << 16);
        unsigned inc = packed;
#pragma unroll
        for (int o = 1; o < 64; o <<= 1) { const unsigned t = __shfl_up(inc, o); if (lane >= o) inc += t; }
        if (lane == 63) misc[8 + wid] = inc;
        __syncthreads();
        unsigned woff = 0u, total = 0u;
#pragma unroll
        for (int w = 0; w < 8; ++w) { const unsigned t = misc[8 + w]; if (w < wid) woff += t; total += t; }
        const unsigned exc = woff + inc - packed; unsigned gt_pre = exc & 0xffffu, eq_pre = exc >> 16; const unsigned total_gt = total & 0xffffu;
        if (tid < nact) for (int j = 0; j < per; ++j) { const int i = tid * per + j; const unsigned k = keys[i]; int slot = -1;
            if (k > thr) { slot = (int)gt_pre; ++gt_pre; } else if (k == thr) { if (eq_pre < need_eq) slot = (int)(total_gt + eq_pre); ++eq_pre; }
            const int row = rowbase + i;
            SLOT[(size_t)row * 16 + e] = (slot >= 0) ? (slotbase + slot) : -1;
            if (slot >= 0) { IDX[slotbase + slot] = row; GATE[slotbase + slot] = __uint_as_float(k); } }
        __syncthreads();
    }
}

DI void phase_ln2(const Params& p, int L, bool need_ctx) {
    const int tid = otid(); const int wid = tid >> 6, lane = tid & 63;
    float* X = (float*)(p.ws + OFF_X); const bf16_t* YS = (const bf16_t*)(p.ws + OFF_YS); const int* SLOT = (const int*)(p.ws + OFF_SLOT); bf16_t* U = (bf16_t*)(p.ws + OFF_U);
    const float* lg = p.in[I_LN2G] + L * 1024; const float* lb = p.in[I_LN2B] + L * 1024;
    const int nrows = need_ctx ? MALL : NL; const bool last = (L == 3);
    for (int r = blockIdx.x * 8 + wid; r < nrows; r += gridDim.x * 8) {
        const int mm = mod_of_row(r); const float* g2 = mods_ptr(p, L, mm, 5);
        const int sv = (lane < 16) ? SLOT[(size_t)r * 16 + lane] : -1;
        f32x4 f[4];
#pragma unroll
        for (int i = 0; i < 4; ++i) f[i] = (f32x4){0.f, 0.f, 0.f, 0.f};
        for (int e = 0; e < 16; ++e) { const int s = __shfl(sv, e); if (s >= 0) {
#pragma unroll
            for (int i = 0; i < 4; ++i) { const u32x2 w = *(const u32x2*)(YS + (size_t)s * 1024 + i * 256 + lane * 4); f[i][0] += bflo(w.x); f[i][1] += bfhi(w.x); f[i][2] += bflo(w.y); f[i][3] += bfhi(w.y); } } }
        f32x4 v[4]; float s = 0.f;
#pragma unroll
        for (int i = 0; i < 4; ++i) { const int c = i * 256 + lane * 4; const f32x4 x = *(const f32x4*)(X + (size_t)r * 1024 + c), g = *(const f32x4*)(g2 + c);
            v[i] = ALPHA * x + g * f[i]; s += (v[i][0] + v[i][1]) + (v[i][2] + v[i][3]); }
        const float mean = wave_sum(s) * (1.0f / 1024.0f); float q = 0.f;
#pragma unroll
        for (int i = 0; i < 4; ++i) { v[i] = v[i] - mean; q += (v[i][0] * v[i][0] + v[i][1] * v[i][1]) + (v[i][2] * v[i][2] + v[i][3] * v[i][3]); }
        const float rstd = 1.0f / sqrtf(wave_sum(q) * (1.0f / 1024.0f) + LN_EPS);
#pragma unroll
        for (int i = 0; i < 4; ++i) { const int c = i * 256 + lane * 4; const f32x4 x2 = v[i] * rstd * *(const f32x4*)(lg + c) + *(const f32x4*)(lb + c);
            if (last) { *(f32x4*)(p.out + (size_t)r * 1024 + c) = x2; }
            else { *(f32x4*)(X + (size_t)r * 1024 + c) = x2;
                const f32x4 t = x2 * (1.0f + *(const f32x4*)(mods_ptr(p, L + 1, mm, 1) + c)) + *(const f32x4*)(mods_ptr(p, L + 1, mm, 0) + c);
                u32x2 w; w.x = pk_bf16(t[0], t[1]); w.y = pk_bf16(t[2], t[3]); *(u32x2*)(U + (size_t)r * 1024 + c) = w; } }
    }
}

DI int crow16(int i, int h) { return (i & 3) + 8 * (i >> 2) + 4 * h; }
DI void phase_attn(const Params& p, int slot, bool need_ctx, LAS char* lds) {
    const int tid = otid(), wid = tid >> 6, lane = tid & 63, r = lane & 31, h = lane >> 5;
    const bf16_t* Z = (const bf16_t*)(p.ws + OFF_Z); bf16_t* O = (bf16_t*)(p.ws + OFF_Z2); const float* sink = p.in[I_SINK] + slot * 16;
    const int nunits = 2048 + (need_ctx ? 32 : 0);
    const int lrow = tid >> 3, lch = tid & 7;
    const int g16 = lane >> 4, i16 = lane & 15;
    const int vtr_off = (4 * h + (i16 >> 2)) * 144 + (16 * (g16 & 1) + 4 * (i16 & 3)) * 2;
    for (int u = blockIdx.x; u < nunits; u += gridDim.x) {
        int b, kvh, qb, qrow0, ntile, tlo;
        if (u < 2048) { b = u >> 10; kvh = (u >> 8) & 3; qb = u & 255; qrow0 = b * SEQ + qb * 64; tlo = (qb < 2) ? (2 - qb) : 0; const int thi = (257 - qb < 4) ? (257 - qb) : 4; ntile = 4 + (thi - tlo + 1); }
        else { const int v = u - 2048; b = v >> 4; kvh = (v >> 2) & 3; qb = v & 3; qrow0 = NL + b * 256 + qb * 64; tlo = 0; ntile = 4; }
        const int hq = kvh * 4 + (wid >> 1), qs = wid & 1; const int qrow = qrow0 + 32 * qs + r;
        bf16x8 qf[4];
#pragma unroll
        for (int ds = 0; ds < 4; ++ds) qf[ds] = *(const bf16x8*)(Z + (size_t)qrow * 1536 + hq * 64 + 16 * ds + 8 * h);
        float m2 = sink[hq] * LOG2E, l = (h == 0) ? 1.0f : 0.0f;
        f32x16 oacc[2];
#pragma unroll
        for (int i = 0; i < 16; ++i) { oacc[0][i] = 0.f; oacc[1][i] = 0.f; }
        u32x4 kreg, vreg;
#define TILE_ROW(s) (((s) < 4) ? (NL + b * 256 + 64 * (s)) : (b * SEQ + 64 * (qb - 2 + tlo + ((s) - 4))))
        { const size_t g = (size_t)(TILE_ROW(0) + lrow) * 1536 + kvh * 64 + lch * 8; kreg = *(const u32x4*)(Z + g + 1024); vreg = *(const u32x4*)(Z + g + 1280); }
        __syncthreads();
        *(LAS u32x4*)(lds + lrow * 144 + lch * 16) = kreg; *(LAS u32x4*)(lds + 18432 + lrow * 144 + lch * 16) = vreg;
        __syncthreads();
        for (int s = 0; s < ntile; ++s) {
            const int buf = s & 1;
            if (s + 1 < ntile) { const size_t g = (size_t)(TILE_ROW(s + 1) + lrow) * 1536 + kvh * 64 + lch * 8; kreg = *(const u32x4*)(Z + g + 1024); vreg = *(const u32x4*)(Z + g + 1280); }
            const LAS char* Kb = lds + buf * 9216; const LAS char* Vb = lds + 18432 + buf * 9216;
            int mt = 0; if (s >= 4) { const int t = tlo + (s - 4); mt = (t == 0) ? 1 : ((t == 4) ? 2 : 0); }
            f32x16 sa[2];
#pragma unroll
            for (int kb = 0; kb < 2; ++kb) {
#pragma unroll
                for (int i = 0; i < 16; ++i) sa[kb][i] = 0.f;
#pragma unroll
                for (int ds = 0; ds < 4; ++ds) { const bf16x8 kf = *(const LAS bf16x8*)(Kb + (32 * kb + r) * 144 + (16 * ds + 8 * h) * 2);
                    sa[kb] = __builtin_amdgcn_mfma_f32_32x32x16_bf16(kf, qf[ds], sa[kb], 0, 0, 0); }
            }
            const int iq = 32 * qs + r; float mx = -3.0e38f;
#pragma unroll
            for (int kb = 0; kb < 2; ++kb)
#pragma unroll
                for (int i = 0; i < 16; ++i) { float sv = sa[kb][i] * LOG2E; const int j = 32 * kb + crow16(i, h);
                    if (mt == 1 && j < iq) sv = -1.0e30f; if (mt == 2 && j > iq) sv = -1.0e30f; sa[kb][i] = sv; mx = fmaxf(mx, sv); }
            mx = fmaxf(mx, __shfl_xor(mx, 32));
            const float mn = fmaxf(m2, mx), alpha = __builtin_amdgcn_exp2f(m2 - mn); m2 = mn;
            float ls = 0.f;
#pragma unroll
            for (int kb = 0; kb < 2; ++kb)
#pragma unroll
                for (int i = 0; i < 16; ++i) { const float pv = __builtin_amdgcn_exp2f(sa[kb][i] - mn); sa[kb][i] = pv; ls += pv; }
            l = l * alpha + ls;
#pragma unroll
            for (int i = 0; i < 16; ++i) { oacc[0][i] *= alpha; oacc[1][i] *= alpha; }
            bf16x8 pf[2][2];
#pragma unroll
            for (int kb = 0; kb < 2; ++kb)
#pragma unroll
                for (int s2 = 0; s2 < 2; ++s2) { u32x4 w; w.x = pk_bf16(sa[kb][8 * s2 + 0], sa[kb][8 * s2 + 1]); w.y = pk_bf16(sa[kb][8 * s2 + 2], sa[kb][8 * s2 + 3]);
                    w.z = pk_bf16(sa[kb][8 * s2 + 4], sa[kb][8 * s2 + 5]); w.w = pk_bf16(sa[kb][8 * s2 + 6], sa[kb][8 * s2 + 7]); pf[kb][s2] = __builtin_bit_cast(bf16x8, w); }
#pragma unroll
            for (int db = 0; db < 2; ++db)
#pragma unroll
                for (int kb = 0; kb < 2; ++kb)
#pragma unroll
                    for (int s2 = 0; s2 < 2; ++s2) { const LAS char* vp = Vb + vtr_off + (32 * kb + 16 * s2) * 144 + 64 * db;
                        const s16x4 lo = __builtin_bit_cast(s16x4, __builtin_amdgcn_ds_read_tr16_b64_v4i16((LAS s16x4*)vp));
                        const s16x4 hi = __builtin_bit_cast(s16x4, __builtin_amdgcn_ds_read_tr16_b64_v4i16((LAS s16x4*)(vp + 8 * 144)));
                        const bf16x8 vf = (bf16x8){lo[0], lo[1], lo[2], lo[3], hi[0], hi[1], hi[2], hi[3]};
                        oacc[db] = __builtin_amdgcn_mfma_f32_32x32x16_bf16(vf, pf[kb][s2], oacc[db], 0, 0, 0); }
            if (s + 1 < ntile) { const int nb = (s + 1) & 1; *(LAS u32x4*)(lds + nb * 9216 + lrow * 144 + lch * 16) = kreg; *(LAS u32x4*)(lds + 18432 + nb * 9216 + lrow * 144 + lch * 16) = vreg; }
            __syncthreads();
        }
        const float lt = l + __shfl_xor(l, 32); const float inv = 1.0f / lt;
#pragma unroll
        for (int db = 0; db < 2; ++db)
#pragma unroll
            for (int gq = 0; gq < 4; ++gq) { u32x2 w; w.x = pk_bf16(oacc[db][4 * gq + 0] * inv, oacc[db][4 * gq + 1] * inv); w.y = pk_bf16(oacc[db][4 * gq + 2] * inv, oacc[db][4 * gq + 3] * inv);
                *(u32x2*)(O + (size_t)qrow * 1024 + hq * 64 + 32 * db + 8 * gq + 4 * h) = w; }
    }
    __syncthreads();
}

DI void phase_lru_conv4(const Params& p) {
    const bf16_t* Z = (const bf16_t*)(p.ws + OFF_Z); bf16_t* XR = (bf16_t*)(p.ws + OFF_U); const float* cw = p.in[I_LCW]; const float* cb = p.in[I_LCB];
    const int tid = otid();
    for (int it = blockIdx.x * NTHREADS + tid; it < MALL * 128; it += gridDim.x * NTHREADS) {
        const int row = it >> 7, c8 = (it & 127) * 8; int t, len; if (row < NL) { t = row & (SEQ - 1); len = SEQ; } else { t = (row - NL) & 255; len = 256; }
        float acc[8]; { const f32x4 b0 = *(const f32x4*)(cb + c8), b1 = *(const f32x4*)(cb + c8 + 4); acc[0] = b0[0]; acc[1] = b0[1]; acc[2] = b0[2]; acc[3] = b0[3]; acc[4] = b1[0]; acc[5] = b1[1]; acc[6] = b1[2]; acc[7] = b1[3]; }
#pragma unroll
        for (int j = 0; j < 4; ++j) { const int tt = t + j - 2; if (tt >= 0 && tt < len) {
            const u32x4 w = *(const u32x4*)(Z + (size_t)(row + j - 2) * 2048 + 1024 + c8); const f32x4 w0 = *(const f32x4*)(cw + j * 1024 + c8), w1 = *(const f32x4*)(cw + j * 1024 + c8 + 4);
            acc[0] += w0[0] * bflo(w.x); acc[1] += w0[1] * bfhi(w.x); acc[2] += w0[2] * bflo(w.y); acc[3] += w0[3] * bfhi(w.y);
            acc[4] += w1[0] * bflo(w.z); acc[5] += w1[1] * bfhi(w.z); acc[6] += w1[2] * bflo(w.w); acc[7] += w1[3] * bfhi(w.w); } }
        u32x4 o; o.x = pk_bf16(acc[0], acc[1]); o.y = pk_bf16(acc[2], acc[3]); o.z = pk_bf16(acc[4], acc[5]); o.w = pk_bf16(acc[6], acc[7]);
        *(u32x4*)(XR + (size_t)row * 1024 + c8) = o;
    }
}
DI int chunk_row0(int q) { if (q < 512) return (q >> 8) * SEQ + (q & 255) * 64; const int v = q - 512; return NL + (v >> 2) * 256 + (v & 3) * 64; }
DI void phase_scan1(const Params& p) {
    const int tid = otid();
    const float* AC = (const float*)(p.ws + OFF_BIG); const float* BC = AC + (size_t)2 * MALL * 1024; f32x2* PQ = (f32x2*)(p.ws + OFF_PQ);
    for (int u = blockIdx.x; u < NCHUNK * 4; u += gridDim.x) {
        const int q = u >> 2, dir = (u >> 1) & 1, ch = (u & 1) * 512 + tid; const int r0 = chunk_row0(q);
        const float* a = AC + ((size_t)dir * MALL + r0) * 1024 + ch; const float* bb = BC + ((size_t)dir * MALL + r0) * 1024 + ch;
        float P = 1.f, Q = 0.f;
        if (dir == 0) {
#pragma unroll 8
            for (int t = 0; t < 64; ++t) { const float av = a[(size_t)t * 1024], bv = bb[(size_t)t * 1024]; Q = av * Q + bv; P *= av; }
        } else {
#pragma unroll 8
            for (int t = 63; t >= 0; --t) { const float av = a[(size_t)t * 1024], bv = bb[(size_t)t * 1024]; Q = av * Q + bv; P *= av; }
        }
        PQ[((size_t)dir * NCHUNK + q) * 1024 + ch] = (f32x2){P, Q};
    }
}
DI void phase_scan2(const Params& p) {
    const f32x2* PQ = (const f32x2*)(p.ws + OFF_PQ); float* CIN = (float*)(p.ws + OFF_CIN);
    const int gid = blockIdx.x * NTHREADS + otid(); if (gid >= 4096) return;
    const int b = gid >> 11, dir = (gid >> 10) & 1, ch = gid & 1023;
    float hst = 0.f;
    for (int j = 0; j < 4; ++j) { const int q = 512 + b * 4 + (dir == 0 ? j : 3 - j); const size_t o = ((size_t)dir * NCHUNK + q) * 1024 + ch; CIN[o] = hst; const f32x2 pq = PQ[o]; hst = pq.x * hst + pq.y; }
#pragma unroll 8
    for (int j = 0; j < 256; ++j) { const int q = b * 256 + (dir == 0 ? j : 255 - j); const size_t o = ((size_t)dir * NCHUNK + q) * 1024 + ch; CIN[o] = hst; const f32x2 pq = PQ[o]; hst = pq.x * hst + pq.y; }
}
DI void phase_scan3(const Params& p) {
    const float* AC = (const float*)(p.ws + OFF_BIG); const float* BC = AC + (size_t)2 * MALL * 1024; const float* CIN = (const float*)(p.ws + OFF_CIN);
    const int tid = otid();
    const bf16_t* Z = (const bf16_t*)(p.ws + OFF_Z); bf16_t* O = (bf16_t*)(p.ws + OFF_Z2);
    for (int u = blockIdx.x; u < NCHUNK * 2; u += gridDim.x) {
        const int q = u >> 1, ch = (u & 1) * 512 + tid; const int r0 = chunk_row0(q);
        float hf[64];
        { const float* a = AC + ((size_t)r0) * 1024 + ch; const float* bb = BC + ((size_t)r0) * 1024 + ch; float hst = CIN[((size_t)q) * 1024 + ch];
#pragma unroll
          for (int t = 0; t < 64; ++t) { hst = a[(size_t)t * 1024] * hst + bb[(size_t)t * 1024]; hf[t] = hst; } }
        { const float* a = AC + ((size_t)MALL + r0) * 1024 + ch; const float* bb = BC + ((size_t)MALL + r0) * 1024 + ch; float hst = CIN[((size_t)NCHUNK + q) * 1024 + ch];
#pragma unroll
          for (int t = 63; t >= 0; --t) { hst = a[(size_t)t * 1024] * hst + bb[(size_t)t * 1024]; const float g = bf2f(Z[(size_t)(r0 + t) * 2048 + ch]);
              O[(size_t)(r0 + t) * 1024 + ch] = (bf16_t)(pk_bf16((hf[t] + hst) * g, 0.f) & 0xffffu); } }
    }
}

DI void phase_dwconv(const Params& p, LAS char* lds) {
    const int tid = otid(), wid = tid >> 6, lane = tid & 63, c0 = 2 * tid;
    const bf16_t* Z = (const bf16_t*)(p.ws + OFF_Z); bf16_t* O = (bf16_t*)(p.ws + OFF_Z2);
    LAS float* part = (LAS float*)(lds + 46 * 2048);
    f32x2 w[31];
#pragma unroll
    for (int k = 0; k < 31; ++k) w[k] = *(const f32x2*)(p.in[I_CDW] + k * 1024 + c0);
    const f32x2 bias = *(const f32x2*)(p.in[I_CDB] + c0), lg = *(const f32x2*)(p.in[I_CLNG] + c0), lb = *(const f32x2*)(p.in[I_CLNB] + c0);
    for (int u = blockIdx.x; u < 2048 + 32; u += gridDim.x) {
        int t0, seq0, len; if (u < 2048) { seq0 = (u >> 10) * SEQ; t0 = (u & 1023) * 16; len = SEQ; } else { const int v = u - 2048; seq0 = NL + (v >> 4) * 256; t0 = (v & 15) * 16; len = 256; }
        __syncthreads();
        for (int i = tid; i < 46 * 128; i += NTHREADS) { const int j = i >> 7, c = i & 127; const int t = t0 - 15 + j; u32x4 v = (u32x4){0u, 0u, 0u, 0u};
            if (t >= 0 && t < len) v = *(const u32x4*)(Z + (size_t)(seq0 + t) * 1024 + c * 8);
            *(LAS u32x4*)(lds + j * 2048 + c * 16) = v; }
        __syncthreads();
#pragma unroll 1
        for (int hf = 0; hf < 2; ++hf) {
            float a0[8], a1[8];
#pragma unroll
            for (int i = 0; i < 8; ++i) { a0[i] = bias.x; a1[i] = bias.y; }
            const LAS char* zb = lds + hf * 8 * 2048 + tid * 4;
#pragma unroll
            for (int j = 0; j < 38; ++j) { const unsigned zw = *(const LAS unsigned*)(zb + j * 2048); const float z0 = bflo(zw), z1 = bfhi(zw);
#pragma unroll
                for (int i = 0; i < 8; ++i) { const int k = j - i; if (k >= 0 && k <= 30) { a0[i] += w[k].x * z0; a1[i] += w[k].y * z1; } }
                if ((j & 3) == 3) asm volatile("" ::: "memory"); }
#pragma unroll
            for (int i = 0; i < 8; ++i) { const float s = wave_sum(a0[i] + a1[i]); if (lane == 0) part[wid * 8 + i] = s; }
            __syncthreads();
            float mean[8];
#pragma unroll
            for (int i = 0; i < 8; ++i) { float s = 0.f;
#pragma unroll
                for (int ww = 0; ww < 8; ++ww) s += part[ww * 8 + i]; mean[i] = s * (1.0f / 1024.0f); }
#pragma unroll
            for (int i = 0; i < 8; ++i) { const float d0 = a0[i] - mean[i], d1 = a1[i] - mean[i]; const float s = wave_sum(d0 * d0 + d1 * d1); if (lane == 0) part[64 + wid * 8 + i] = s; }
            __syncthreads();
#pragma unroll
            for (int i = 0; i < 8; ++i) { float s = 0.f;
#pragma unroll
                for (int ww = 0; ww < 8; ++ww) s += part[64 + ww * 8 + i];
                const float rstd = 1.0f / sqrtf(s * (1.0f / 1024.0f) + LN_EPS);
                const float y0 = (a0[i] - mean[i]) * rstd * lg.x + lb.x, y1 = (a1[i] - mean[i]) * rstd * lg.y + lb.y;
                *(unsigned*)(O + (size_t)(seq0 + t0 + hf * 8 + i) * 1024 + c0) = pk_bf16(siluf_(y0), siluf_(y1)); }
            __syncthreads();
        }
    }
    __syncthreads();
}

constexpr int N_PHASES = 38;
#if MK_ONE_LAUNCH
#define SEAM() xcd_barrier(bar)
#else
#define SEAM() do {} while (0)
#endif

__global__ void __launch_bounds__(NTHREADS, 2) fwd_kernel(Params p) {
    extern __shared__ __attribute__((aligned(16))) unsigned char lds_raw[];
    LAS char* lds = (LAS char*)lds_raw;
    volatile LAS unsigned* MISC = (volatile LAS unsigned*)(lds + LDS_MISC);
    if (threadIdx.x < 64) MISC[threadIdx.x] = 0u;
    __syncthreads();
#if MK_ONE_LAUNCH
    XcdBarrier bar = xcd_barrier_post((unsigned*)(p.ws + OFF_CTL), MISC + 8);
#endif
    const int lo = p.ph_lo, hi = p.ph_hi;
#ifdef PH_ONLY
#define IN(k) ((k) == PH_ONLY && lo <= (k) && (k) < hi)
#else
#define IN(k) (lo <= (k) && (k) < hi)
#endif
#define END(k) do { if (IN((k) + 1)) SEAM(); } while (0)
    const bf16_t* Ub = (const bf16_t*)(p.ws + OFF_U); const bf16_t* Tb = (const bf16_t*)(p.ws + OFF_T); bf16_t* Zb = (bf16_t*)(p.ws + OFF_Z); const bf16_t* Z2b = (const bf16_t*)(p.ws + OFF_Z2);
    float* Yb = (float*)(p.ws + OFF_Y);

    if (IN(0)) { phase_prologue(p, lds); END(0); }
    if (IN(1)) { phase_init(p); END(1); }

#define MOE_PART(PH0, L, NEEDCTX) \
    if (IN(PH0)) { phase_ln1(p, L, NEEDCTX, lds); END(PH0); } \
    if (IN(PH0 + 1)) { phase_topk(p, NEEDCTX, lds); END(PH0 + 1); } \
    if (IN(PH0 + 2)) { SchedMoe1 S{Tb, (const int*)(p.ws + OFF_IDX), (const bf16_t*)(p.ws + OFF_WMOE) + (size_t)(L) * 16 * MOE_E_ELEMS, 4096 + ((NEEDCTX) ? 256 : 0)}; \
        EpiSwiglu E{(bf16_t*)(p.ws + OFF_HID)}; GEMM_PHASE(lds, S, E); END(PH0 + 2); } \
    if (IN(PH0 + 3)) { SchedMoe2 S{(const bf16_t*)(p.ws + OFF_HID), (const bf16_t*)(p.ws + OFF_WMOE) + (size_t)(L) * 16 * MOE_E_ELEMS, 1024 + ((NEEDCTX) ? 64 : 0)}; \
        EpiMoeOut E{(bf16_t*)(p.ws + OFF_YS), (const float*)(p.ws + OFF_GATE)}; GEMM_PHASE(lds, S, E); END(PH0 + 3); } \
    if (IN(PH0 + 4)) { phase_ln2(p, L, NEEDCTX); END(PH0 + 4); }

#define ATTN_PART(PH0, SLOTI, NEEDCTX) \
    if (IN(PH0)) { SchedDense S{Ub, (const bf16_t*)(p.ws + OFF_WQKV) + (size_t)(SLOTI) * 1536 * 1024, 1024, 1024, 6, 130 * 6}; \
        EpiQkv E{Zb, (const float*)(p.ws + OFF_ROPE)}; GEMM_PHASE(lds, S, E); END(PH0); } \
    if (IN(PH0 + 1)) { phase_attn(p, SLOTI, NEEDCTX, lds); END(PH0 + 1); } \
    if (IN(PH0 + 2)) { SchedDense S{Z2b, (const bf16_t*)(p.ws + OFF_WO) + (size_t)(SLOTI) * 1024 * 1024, 1024, 1024, 4, 130 * 4}; \
        EpiF32 E{Yb, nullptr}; GEMM_PHASE(lds, S, E); END(PH0 + 2); }

    ATTN_PART(2, 0, true)
    MOE_PART(5, 0, true)
    if (IN(10)) { SchedDense S{Ub, (const bf16_t*)(p.ws + OFF_LWIN), 1024, 1024, 8, 130 * 8}; EpiLruIn E{Zb}; GEMM_PHASE(lds, S, E); END(10); }
    if (IN(11)) { phase_lru_conv4(p); END(11); }
    if (IN(12)) { SchedGates S{Ub, (const bf16_t*)(p.ws + OFF_LGATE), 130 * 16};
        EpiGates E{(float*)(p.ws + OFF_BIG), (float*)(p.ws + OFF_BIG) + (size_t)2 * MALL * 1024, Ub, p.in[I_LGAB], p.in[I_LGXB], (const float*)(p.ws + OFF_SP)}; GEMM_PHASE(lds, S, E); END(12); }
    if (IN(13)) { phase_scan1(p); END(13); }
    if (IN(14)) { phase_scan2(p); END(14); }
    if (IN(15)) { phase_scan3(p); END(15); }
    if (IN(16)) { SchedDense S{Z2b, (const bf16_t*)(p.ws + OFF_LWOUT), 1024, 1024, 4, 130 * 4}; EpiF32 E{Yb, nullptr}; GEMM_PHASE(lds, S, E); END(16); }
    MOE_PART(17, 1, true)
    if (IN(22)) { SchedDense S{Ub, (const bf16_t*)(p.ws + OFF_CWIN), 1024, 1024, 8, 130 * 8}; EpiGlu E{Zb, p.in[I_CBIN]}; GEMM_PHASE(lds, S, E); END(22); }
    if (IN(23)) { phase_dwconv(p, lds); END(23); }
    if (IN(24)) { SchedDense S{Z2b, (const bf16_t*)(p.ws + OFF_CWOUT), 1024, 1024, 4, 130 * 4}; EpiF32 E{Yb, p.in[I_CBOUT]}; GEMM_PHASE(lds, S, E); END(24); }
    MOE_PART(25, 2, true)
    ATTN_PART(30, 1, false)
    MOE_PART(33, 3, false)
#undef IN
#undef END
}

extern "C" void kernel_launch(void* const* d_in, const int* in_sizes, int n_in, void* d_out, int out_size, void* d_ws, size_t ws_size, hipStream_t stream) {
    static int grid = 0;
    if (grid == 0) {
        if (n_in != 34 || in_sizes[0] != NL * D || out_size != NL * D || ws_size < WS_TOTAL) {
            fprintf(stderr, "kernel_launch: unexpected problem (n_in %d, in0 %d, out %d, ws %zu < %zu); nothing launched\n", n_in, n_in > 0 ? in_sizes[0] : -1, out_size, ws_size, (size_t)WS_TOTAL); grid = -1; return; }
        int dev = 0, cus = 0, per_cu = 0;
        if (hipGetDevice(&dev) != hipSuccess || hipDeviceGetAttribute(&cus, hipDeviceAttributeMultiprocessorCount, dev) != hipSuccess) { grid = -1; return; }
        if (hipFuncSetAttribute((const void*)fwd_kernel, hipFuncAttributeMaxDynamicSharedMemorySize, LDS_BYTES) != hipSuccess) { fprintf(stderr, "kernel_launch: hipFuncSetAttribute failed\n"); grid = -1; return; }
        if (hipOccupancyMaxActiveBlocksPerMultiprocessor(&per_cu, (const void*)fwd_kernel, NTHREADS, LDS_BYTES) != hipSuccess || per_cu < 1) fprintf(stderr, "kernel_launch: occupancy query says %d\n", per_cu);
        (void)hipGetLastError();
        grid = cus > 256 ? 256 : cus;
    }
    if (grid < 0) return;
    if (hipMemsetAsync((char*)d_ws + OFF_CTL, 0, CTL_BYTES, stream) != hipSuccess) return;
    Params p{};
    for (int i = 0; i < 34; ++i) p.in[i] = (const float*)d_in[i];
    p.out = (float*)d_out; p.ws = (char*)d_ws;
#if MK_ONE_LAUNCH
    p.ph_lo = 0; p.ph_hi = N_PHASES;
    hipLaunchKernelGGL(fwd_kernel, dim3(grid), dim3(NTHREADS), LDS_BYTES, stream, p);
#else
    for (int k = 0; k < N_PHASES; ++k) { p.ph_lo = k; p.ph_hi = k + 1; hipLaunchKernelGGL(fwd_kernel, dim3(grid), dim3(NTHREADS), LDS_BYTES, stream, p); }
#endif
}
```
